# Optimizing an MI355X kernel written in HIP

```python
import jax, jax.numpy as jnp
from jax import lax
import numpy as np

D_MODEL = 1024
BATCH = 16
SEQ = 2048
DEPTH = 1

CHUNK = 64
GLA_HEADS = 4
GLA_DK = D_MODEL // 2 // GLA_HEADS
GLA_DV = D_MODEL // GLA_HEADS
GLA_K_WIDTH = GLA_HEADS * GLA_DK
GLA_V_WIDTH = GLA_HEADS * GLA_DV
GK_RANK = 16
GATE_NORMALIZER = 16.0
ATT_HEADS = 16
ATT_DH = 64
ATT_WIDTH = ATT_HEADS * ATT_DH
LEFT_CHUNKS = 8
PAD = LEFT_CHUNKS * CHUNK
BAND = PAD + CHUNK
MAX_REL = 256
N_BRANCH = 2
RMS_EPS = 1e-6

IN_SPLITS = [GLA_K_WIDTH, GLA_K_WIDTH, GLA_V_WIDTH, GLA_V_WIDTH, GK_RANK,
             ATT_WIDTH, ATT_WIDTH, ATT_WIDTH, ATT_WIDTH, N_BRANCH * D_MODEL]
IN_COLS = int(sum(IN_SPLITS))

kernel_name = "hybrid_gla_chunkattn_gated_block"


def rms_norm(x, g):
    xf = x.astype(jnp.float32)
    y = xf * lax.rsqrt(jnp.mean(xf * xf, axis=-1, keepdims=True) + RMS_EPS)
    return (y * g.astype(jnp.float32)).astype(x.dtype)


def gla_branch(q, k, v, gk_code, g_path, gk_up, gk_bias, gla_norm_g, w_o_gla):
    B, T, _ = q.shape
    NC = T // CHUNK
    q = q.reshape(B, NC, CHUNK, GLA_HEADS, GLA_DK) * (GLA_DK ** -0.5)
    k = k.reshape(B, NC, CHUNK, GLA_HEADS, GLA_DK)
    v = v.reshape(B, NC, CHUNK, GLA_HEADS, GLA_DV)
    gk = jax.nn.log_sigmoid((gk_code @ gk_up + gk_bias).astype(jnp.float32)) / GATE_NORMALIZER
    gk = gk.reshape(B, NC, CHUNK, GLA_HEADS, GLA_DK)
    a_cum = jnp.cumsum(gk, axis=2)
    a_end = a_cum[:, :, -1]
    k_dec = (k.astype(jnp.float32) * jnp.exp(a_end[:, :, None] - a_cum)).astype(k.dtype)
    upd = jnp.einsum('bnchk,bnchv->bnhkv', k_dec, v)
    decay = jnp.exp(a_end).astype(upd.dtype)

    def step(state, inp):
        d, u = inp
        state = d[..., None] * state + u
        return state, state

    init = jnp.zeros((B, GLA_HEADS, GLA_DK, GLA_DV), upd.dtype)
    _, s_all = lax.scan(step, init, (jnp.moveaxis(decay, 1, 0), jnp.moveaxis(upd, 1, 0)))
    s_all = jnp.moveaxis(s_all, 0, 1)
    o = jnp.einsum('bnchk,bnhkv->bnchv', q, s_all)
    o = rms_norm(o, gla_norm_g).reshape(B, T, GLA_V_WIDTH)
    return (o * jax.nn.silu(g_path)) @ w_o_gla


def chunk_attention_branch(q, k, v, g_path, rel_bias, w_o_att):
    B, T, _ = q.shape
    NC = T // CHUNK
    q = q.reshape(B, T, ATT_HEADS, ATT_DH)
    k = k.reshape(B, T, ATT_HEADS, ATT_DH)
    v = v.reshape(B, T, ATT_HEADS, ATT_DH)
    k_pad = jnp.pad(k, ((0, 0), (PAD, 0), (0, 0), (0, 0)))
    v_pad = jnp.pad(v, ((0, 0), (PAD, 0), (0, 0), (0, 0)))
    dist = np.arange(CHUNK)[:, None] + PAD - np.arange(BAND)[None, :]
    rel_idx = np.clip(dist, -MAX_REL, MAX_REL) + MAX_REL
    bias = rel_bias[:, rel_idx].astype(jnp.float32)
    band_pos = jnp.arange(BAND)
    scale = ATT_DH ** -0.5

    def attend(c):
        qb = lax.dynamic_slice_in_dim(q, c * CHUNK, CHUNK, axis=1)
        kb = lax.dynamic_slice_in_dim(k_pad, c * CHUNK, BAND, axis=1)
        vb = lax.dynamic_slice_in_dim(v_pad, c * CHUNK, BAND, axis=1)
        s = jnp.einsum('bqhd,bkhd->bhqk', qb, kb).astype(jnp.float32) * scale + bias
        valid = band_pos >= PAD - c * CHUNK
        s = jnp.where(valid, s, -1e30)
        p = jax.nn.softmax(s, axis=-1).astype(vb.dtype)
        return jnp.einsum('bhqk,bkhd->bqhd', p, vb)

    o = lax.map(attend, jnp.arange(NC))
    o = jnp.transpose(o, (1, 0, 2, 3, 4)).reshape(B, T, ATT_WIDTH)
    return (o * jax.nn.silu(g_path)) @ w_o_att


def setup_inputs(seed: int = 0) -> dict:
    key = jax.random.key(seed)
    ks = jax.random.split(key, 12)
    f32 = jnp.float32
    return {
        "x": jax.random.normal(ks[0], (BATCH, SEQ, D_MODEL), f32),
        "norm_pre_g": 1.0 + 0.05 * jax.random.normal(ks[1], (D_MODEL,), f32),
        "w_in": jax.random.normal(ks[2], (D_MODEL, IN_COLS), f32) * D_MODEL ** -0.5,
        "gk_up": jax.random.normal(ks[3], (GK_RANK, GLA_K_WIDTH), f32) * GK_RANK ** -0.5,
        "gk_bias": 0.02 * jax.random.normal(ks[4], (GLA_K_WIDTH,), f32),
        "gla_norm_g": 1.0 + 0.05 * jax.random.normal(ks[5], (GLA_DV,), f32),
        "rel_bias": 0.1 * jax.random.normal(ks[6], (ATT_HEADS, 2 * MAX_REL + 1), f32),
        "w_o_gla": jax.random.normal(ks[7], (GLA_V_WIDTH, D_MODEL), f32) * GLA_V_WIDTH ** -0.5,
        "w_o_att": jax.random.normal(ks[8], (ATT_WIDTH, D_MODEL), f32) * ATT_WIDTH ** -0.5,
        "merge_bias": 0.02 * jax.random.normal(ks[9], (N_BRANCH * D_MODEL,), f32),
        "w_out": jax.random.normal(ks[10], (D_MODEL, D_MODEL), f32) * D_MODEL ** -0.5,
        "norm_post_g": 1.0 + 0.05 * jax.random.normal(ks[11], (D_MODEL,), f32),
    }


def reference(x, norm_pre_g, w_in, gk_up, gk_bias, gla_norm_g, rel_bias,
              w_o_gla, w_o_att, merge_bias, w_out, norm_post_g):
    splits = [int(s) for s in np.cumsum(IN_SPLITS)[:-1]]
    for _layer in range(DEPTH):
        h = rms_norm(x, norm_pre_g)
        proj = h @ w_in
        (q_g, k_g, v_g, g_g, gk_code,
         q_a, k_a, v_a, g_a, gate_logits) = jnp.split(proj, splits, axis=-1)
        y_gla = gla_branch(q_g, k_g, v_g, gk_code, g_g, gk_up, gk_bias, gla_norm_g, w_o_gla)
        y_att = chunk_attention_branch(q_a, k_a, v_a, g_a, rel_bias, w_o_att)
        gates = jax.nn.sigmoid(gate_logits + merge_bias)
        gate_gla, gate_att = jnp.split(gates, 2, axis=-1)
        merged = gate_gla * y_gla + gate_att * y_att
        y = merged @ w_out
        x = x + rms_norm(y, norm_post_g)
    return x
```

```cpp
#include <hip/hip_runtime.h>
#include <hip/hip_cooperative_groups.h>
#include <cstdio>
#include <cstdint>
namespace cg = cooperative_groups;
namespace pg8 {
#define PG8_LAS __attribute__((address_space(3)))
typedef unsigned short bf16_t;
typedef short bf16x8 __attribute__((ext_vector_type(8)));
typedef float f32x4 __attribute__((ext_vector_type(4)));
typedef unsigned u32x4 __attribute__((ext_vector_type(4)));
constexpr int BM = 256, BK = 64, HALF = 128, HTB = HALF * BK * 2  , STAGE_BYTES = 8 * HTB, NXCD = 8, WGM = 8;

__host__ __device__ __forceinline__ int lds_byte(int r, int c) { const int st = (r >> 4) * 2 + (c >> 5), rr = r & 15, cc = c & 31, ob = rr * 64 + cc * 2; return st * 1024 + (ob ^ (((ob >> 9) & 1) << 5)); }
__host__ __device__ __forceinline__ void stage_rc(int b, int& R, int& C) { const int st = b / 1024, sb = b % 1024, swz = sb ^ (((sb >> 9) & 1) << 5); R = (st >> 1) * 16 + swz / 64; C = (st & 1) * 32 + (swz % 64) / 2; }
__host__ __device__ __forceinline__ int perm32(int rho) { const int n = rho >> 4, i = rho & 15; return 8 * (i >> 2) + 4 * n + (i & 3); }

struct Unit { int pm, pn; };
struct Gemm { const bf16_t* A; const bf16_t* Bt; int M, N, K, lda, ldb; };

struct StaticOrder {
    int nM, nN, nwg, G, c;
    __host__ __device__ void init(int M, int N, int G_, int c_) { nM = M / BM; nN = N / BM; nwg = nM * nN; G = G_; c = c_; }
    __host__ __device__ bool next(int i, Unit& u) const {
        const long L = (long)i * G + c; if (L >= nwg) return false;
        int wgid = (int)L; { const int q = nwg / NXCD, r = nwg % NXCD, xcd = wgid % NXCD, off = wgid / NXCD; wgid = (xcd < r ? xcd * (q + 1) : r * (q + 1) + (xcd - r) * q) + off; }
        const int nig = WGM * nN, gid = wgid / nig, fm = gid * WGM, gsz = (nM - fm) < WGM ? (nM - fm) : WGM;
        u.pm = fm + ((wgid % nig) % gsz); u.pn = (wgid % nig) / gsz; return true;
    }
    __device__ __forceinline__ void a_ready(const Unit&) const {}
    __device__ __forceinline__ void done(const Unit&) const {}
};

__device__ __forceinline__ unsigned cvt_pk_bf16(float lo, float hi) { unsigned r; asm volatile("v_cvt_pk_bf16_f32 %0, %1, %2" : "=v"(r) : "v"(lo), "v"(hi)); return r; }
typedef float f32x2 __attribute__((ext_vector_type(2)));
__device__ __forceinline__ f32x2 gelu_pk(f32x2 v) {
    const f32x2 av = __builtin_elementwise_abs(v), d = av * 0.2316418882f + 1.0f;
    f32x2 t; t.x = __builtin_amdgcn_rcpf(d.x); t.y = __builtin_amdgcn_rcpf(d.y);
    f32x2 q = t * 0.5307027145f + (-0.7265760135f); q = q * t + 0.7107068705f; q = q * t + (-0.142248368f); q = q * t + 0.127414796f; q = q * t;
    const f32x2 s = (v * v) * (-0.72134752044f);
    f32x2 e; e.x = __builtin_amdgcn_exp2f(s.x); e.y = __builtin_amdgcn_exp2f(s.y);
    const f32x2 m = v * (q * e), r = v - m;
    f32x2 o; o.x = v.x < 0.f ? m.x : r.x; o.y = v.y < 0.f ? m.y : r.y; return o;
}

template <class Epi, class Sched, bool ALIGN_EPI = false, bool SP2 = false>
__device__ __forceinline__ void gemm_phase(PG8_LAS unsigned char* lds, const Gemm g, const Sched& S, const Epi& E) {
    const int tid = threadIdx.x, wid = __builtin_amdgcn_readfirstlane(tid >> 6), lane = tid & 63, wr = wid >> 2, wc = wid & 3, fr = lane & 15, fq = lane >> 4;
    const int K = g.K, nt = K / BK;
    unsigned voffA[2], voffB[2];
#pragma unroll
    for (int i = 0; i < 2; ++i) { int R, C; stage_rc(tid * 16 + i * 8192, R, C); const int Rb = Epi::PERM ? ((R & ~31) + perm32(R & 31)) : R;
        voffA[i] = (unsigned)(R * g.lda + C) * 2u; voffB[i] = (unsigned)(Rb * g.ldb + C) * 2u; }
    const size_t kstep = (size_t)(BK * 2);
    const size_t hstepA = (size_t)HALF * g.lda * 2, hstepB = (size_t)HALF * g.ldb * 2;
    const size_t tstepA = 2 * hstepA, tstepB = 2 * hstepB;
    const unsigned ldsw = (unsigned)wid * 1024u;
    const int aoff = lds_byte(wr * 64 + fr, fq * 8), boff = lds_byte(wc * 32 + fr, fq * 8);
#define PG8_SA(b, h) (((b) * 2 + (h)) * HTB)
#define PG8_SB(b, h) ((4 + (b) * 2 + (h)) * HTB)
#define PG8_STAGE(bufoff, gbase, voff) do { _Pragma("unroll") for (int _i = 0; _i < 2; ++_i) \
        __builtin_amdgcn_global_load_lds((const unsigned*)((const char*)(gbase) + (voff)[_i]), (PG8_LAS unsigned*)(lds + (bufoff) + ldsw + _i * 8192), 16, 0, 0); } while (0)
#define PG8_LDA(dst, b, h) do { _Pragma("unroll") for (int m = 0; m < 4; ++m) _Pragma("unroll") for (int k = 0; k < 2; ++k) dst[m][k] = *(const PG8_LAS bf16x8*)(lds + PG8_SA(b, h) + aoff + m * 2048 + k * 1024); } while (0)
#define PG8_LDB(dst, b, h) do { _Pragma("unroll") for (int n = 0; n < 2; ++n) _Pragma("unroll") for (int k = 0; k < 2; ++k) dst[n][k] = *(const PG8_LAS bf16x8*)(lds + PG8_SB(b, h) + boff + n * 2048 + k * 1024); } while (0)
#define PG8_MMA(ai, bj, At, Bt) do { __builtin_amdgcn_s_setprio(1); _Pragma("unroll") for (int m = 0; m < 4; ++m) _Pragma("unroll") for (int n = 0; n < 2; ++n) _Pragma("unroll") for (int k = 0; k < 2; ++k) \
        acc[ai][bj][m][n] = __builtin_amdgcn_mfma_f32_16x16x32_bf16(Bt[n][k], At[m][k], acc[ai][bj][m][n], 0, 0, 0); __builtin_amdgcn_s_setprio(0); } while (0)
#define PG8_WAIT_V(n) asm volatile("s_waitcnt vmcnt(" #n ")" ::: "memory")
#define PG8_WAIT_L(n) asm volatile("s_waitcnt lgkmcnt(" #n ")" ::: "memory")
#define PG8_BAR __builtin_amdgcn_s_barrier()
#define PG8_SCHED __builtin_amdgcn_sched_barrier(0)
    Unit cur, nxt; int ui = 0;
    if (!S.next(0, cur)) return;
    f32x4 acc[2][2][4][2];
#pragma unroll
    for (int a = 0; a < 2; ++a)
#pragma unroll
        for (int b = 0; b < 2; ++b)
#pragma unroll
            for (int m = 0; m < 4; ++m)
#pragma unroll
                for (int n = 0; n < 2; ++n) acc[a][b][m][n] = (f32x4){0.f, 0.f, 0.f, 0.f};
    bf16x8 At[4][2], B0[2][2], B1[2][2];
    const char* cA = (const char*)g.A + (size_t)cur.pm * tstepA; const char* cB = (const char*)g.Bt + (size_t)cur.pn * tstepB;
    S.a_ready(cur);
    if constexpr (SP2) {
        PG8_STAGE(PG8_SB(0, 0), cB, voffB); PG8_STAGE(PG8_SB(0, 1), cB + hstepB, voffB); PG8_STAGE(PG8_SA(0, 0), cA, voffA); PG8_STAGE(PG8_SA(0, 1), cA + hstepA, voffA);
        if (wr == 1) PG8_BAR;
        PG8_WAIT_V(2); PG8_BAR;
        PG8_STAGE(PG8_SB(1, 0), cB + kstep, voffB); PG8_STAGE(PG8_SA(1, 0), cA + kstep, voffA); PG8_STAGE(PG8_SB(1, 1), cB + hstepB + kstep, voffB);
        PG8_WAIT_V(6); PG8_BAR;
    } else {
        PG8_STAGE(PG8_SB(0, 0), cB, voffB); PG8_STAGE(PG8_SA(0, 0), cA, voffA); PG8_STAGE(PG8_SB(0, 1), cB + hstepB, voffB); PG8_STAGE(PG8_SA(0, 1), cA + hstepA, voffA);
        if (wr == 1) PG8_BAR;
        PG8_WAIT_V(4); PG8_BAR;
        PG8_STAGE(PG8_SB(1, 0), cB + kstep, voffB); PG8_STAGE(PG8_SA(1, 0), cA + kstep, voffA); PG8_STAGE(PG8_SB(1, 1), cB + hstepB + kstep, voffB);
        PG8_WAIT_V(6); PG8_BAR;
    }
    for (;;) {
        const bool has_next = S.next(ui + 1, nxt);
        const char* nA = has_next ? (const char*)g.A + (size_t)nxt.pm * tstepA : cA; const char* nB = has_next ? (const char*)g.Bt + (size_t)nxt.pn * tstepB : cB;
        for (int t = 0; t < nt; t += 2) {
            if constexpr (Epi::HOOK) { PG8_SCHED; if (t == (nt >> 1)) { E.mid(acc, cur, wr, wc, fr, fq); PG8_SCHED; } PG8_SCHED; }
            const bool last = (t == nt - 2);
            const char* a1 = cA + (size_t)(t + 1) * kstep;
            const char* a2 = last ? nA : cA + (size_t)(t + 2) * kstep; const char* b2 = last ? nB : cB + (size_t)(t + 2) * kstep;
            const char* a3 = a2 + kstep; const char* b3 = b2 + kstep;
            if (last && has_next) S.a_ready(nxt);
            if constexpr (SP2) {
            PG8_LDB(B0, 0, 0); PG8_LDB(B1, 0, 1); PG8_SCHED; PG8_LDA(At, 0, 0); PG8_STAGE(PG8_SA(1, 1), a1 + hstepA, voffA);
            PG8_WAIT_V(8); PG8_WAIT_L(0); PG8_BAR; PG8_MMA(0, 0, At, B0); PG8_MMA(0, 1, At, B1); PG8_BAR; PG8_SCHED;
            PG8_LDA(At, 0, 1); PG8_STAGE(PG8_SB(0, 0), b2, voffB); PG8_STAGE(PG8_SB(0, 1), b2 + hstepB, voffB); PG8_STAGE(PG8_SA(0, 0), a2, voffA);
            PG8_WAIT_V(8); PG8_WAIT_L(0); PG8_BAR; PG8_MMA(1, 0, At, B0); PG8_MMA(1, 1, At, B1); PG8_BAR; PG8_SCHED;
            PG8_LDB(B0, 1, 0); PG8_LDB(B1, 1, 1); PG8_SCHED; PG8_LDA(At, 1, 0); PG8_STAGE(PG8_SA(0, 1), a2 + hstepA, voffA);
            PG8_WAIT_V(8); PG8_WAIT_L(0); PG8_BAR; PG8_MMA(0, 0, At, B0); PG8_MMA(0, 1, At, B1); PG8_BAR; PG8_SCHED;
            PG8_LDA(At, 1, 1); PG8_STAGE(PG8_SB(1, 0), b3, voffB); PG8_STAGE(PG8_SB(1, 1), b3 + hstepB, voffB); PG8_STAGE(PG8_SA(1, 0), a3, voffA);
            PG8_WAIT_V(8); PG8_WAIT_L(0); PG8_BAR; PG8_MMA(1, 0, At, B0); PG8_MMA(1, 1, At, B1); PG8_BAR; PG8_SCHED;
            } else {
            PG8_LDB(B0, 0, 0); PG8_SCHED; PG8_LDA(At, 0, 0); PG8_STAGE(PG8_SA(1, 1), a1 + hstepA, voffA);
            PG8_WAIT_L(8); PG8_BAR; PG8_WAIT_L(0); PG8_MMA(0, 0, At, B0); PG8_BAR; PG8_SCHED;
            PG8_LDB(B1, 0, 1); PG8_STAGE(PG8_SB(0, 0), b2, voffB);
            PG8_BAR; PG8_WAIT_L(0); PG8_MMA(0, 1, At, B1); PG8_BAR;
            PG8_LDA(At, 0, 1); PG8_STAGE(PG8_SA(0, 0), a2, voffA);
            PG8_BAR; PG8_WAIT_L(0); PG8_MMA(1, 0, At, B0); PG8_BAR; PG8_SCHED;
            PG8_STAGE(PG8_SB(0, 1), b2 + hstepB, voffB);
            PG8_WAIT_V(6); PG8_BAR; PG8_MMA(1, 1, At, B1); PG8_BAR;
            PG8_LDB(B0, 1, 0); PG8_SCHED; PG8_LDA(At, 1, 0); PG8_STAGE(PG8_SA(0, 1), a2 + hstepA, voffA);
            PG8_WAIT_L(8); PG8_BAR; PG8_WAIT_L(0); PG8_MMA(0, 0, At, B0); PG8_BAR; PG8_SCHED;
            PG8_LDB(B1, 1, 1); PG8_STAGE(PG8_SB(1, 0), b3, voffB);
            PG8_BAR; PG8_WAIT_L(0); PG8_MMA(0, 1, At, B1); PG8_BAR;
            PG8_LDA(At, 1, 1); PG8_STAGE(PG8_SA(1, 0), a3, voffA);
            PG8_BAR; PG8_WAIT_L(0); PG8_MMA(1, 0, At, B0); PG8_BAR; PG8_SCHED;
            PG8_STAGE(PG8_SB(1, 1), b3 + hstepB, voffB);
            PG8_WAIT_V(6); PG8_BAR; PG8_MMA(1, 1, At, B1); PG8_BAR;
            }
        }
        if constexpr (ALIGN_EPI) { if (wr == 0) PG8_BAR; }
        if constexpr (!Epi::AFTER_DRAIN) { E(acc, cur, wr, wc, fr, fq); S.done(cur); }
        if (!has_next) break;
#pragma unroll
        for (int a = 0; a < 2; ++a)
#pragma unroll
            for (int b = 0; b < 2; ++b)
#pragma unroll
                for (int m = 0; m < 4; ++m)
#pragma unroll
                    for (int n = 0; n < 2; ++n) acc[a][b][m][n] = (f32x4){0.f, 0.f, 0.f, 0.f};
        cur = nxt; cA = nA; cB = nB; ++ui;
        if constexpr (ALIGN_EPI) { if (wr == 1) PG8_BAR; }
    }
    PG8_WAIT_V(0);
    if constexpr (!ALIGN_EPI) { if (wr == 0) PG8_BAR; }
    PG8_BAR;
    if constexpr (Epi::AFTER_DRAIN) { E.fused(acc, cur, wr, wc, fr, fq, lds, wid, lane); S.done(cur); }
#undef PG8_SA
#undef PG8_SB
#undef PG8_STAGE
#undef PG8_LDA
#undef PG8_LDB
#undef PG8_MMA
#undef PG8_WAIT_V
#undef PG8_WAIT_L
#undef PG8_BAR
#undef PG8_SCHED
}
}

#define LAS __attribute__((address_space(3)))
typedef unsigned short bf16_t;
typedef short bf16x8 __attribute__((ext_vector_type(8)));
typedef short s16x4 __attribute__((ext_vector_type(4)));
typedef float f32x4 __attribute__((ext_vector_type(4)));
typedef float f32x16 __attribute__((ext_vector_type(16)));
typedef unsigned u32x4 __attribute__((ext_vector_type(4)));
typedef unsigned u32x2 __attribute__((ext_vector_type(2)));

constexpr int NB = 16, T = 2048, D = 1024, M = NB * T;
constexpr int NCH = T / 64;
constexpr int IN_COLS = 9232;
constexpr int N1 = 29 * 256;
constexpr float EPS = 1e-6f;
constexpr size_t MiB = 1u << 20;
constexpr size_t WS_CTL = 0;
constexpr size_t WS_WIN = 1 * MiB;
constexpr size_t WS_WG = 16 * MiB;
constexpr size_t WS_WO = 20 * MiB;
constexpr size_t WS_WOUT = 24 * MiB;
constexpr size_t WS_CODE = 26 * MiB;
constexpr size_t WS_QG = 28 * MiB;
constexpr size_t WS_KG = 60 * MiB;
constexpr size_t WS_VQ = 92 * MiB;
constexpr size_t WS_KA = 220 * MiB;
constexpr size_t WS_VA = 284 * MiB;
constexpr size_t WS_GG = 348 * MiB;
constexpr size_t WS_GA = 412 * MiB;
constexpr size_t WS_END = 476 * MiB;
constexpr int CTL_SSQ = 4096;
constexpr int CTL_CNT = 0;

constexpr int LDS_BYTES = 147456;
constexpr int NTHREADS = 512;

__device__ __forceinline__ unsigned f2bf(float f) { unsigned u = __builtin_bit_cast(unsigned, f); return (u + 0x7fffu + ((u >> 16) & 1u)) >> 16; }
typedef float f32x2_t __attribute__((ext_vector_type(2))); typedef __bf16 bf16x2_t __attribute__((ext_vector_type(2)));
__device__ __forceinline__ unsigned pk2(float lo, float hi) { f32x2_t v = {lo, hi}; bf16x2_t b = __builtin_convertvector(v, bf16x2_t); return __builtin_bit_cast(unsigned, b); }
__device__ __forceinline__ float bf2f(unsigned short h) { return __builtin_bit_cast(float, (unsigned)h << 16); }
__device__ __forceinline__ float bflo(unsigned w) { return __builtin_bit_cast(float, w << 16); }
__device__ __forceinline__ float bfhi(unsigned w) { return __builtin_bit_cast(float, w & 0xffff0000u); }
__device__ __forceinline__ float sigmoidf_(float z) { return 1.0f / (1.0f + __expf(-z)); }
__device__ __forceinline__ float siluf_(float z) { return z / (1.0f + __expf(-z)); }
#define LDS_WAIT() asm volatile("s_waitcnt lgkmcnt(0)" ::: "memory")

namespace pg8 {
struct EpiProj {
    static constexpr bool PERM = true, AFTER_DRAIN = false, HOOK = false;
    unsigned char* ws;
    __device__ __forceinline__ void operator()(const f32x4 (&acc)[2][2][4][2], const Unit& u, int wr, int wc, int fr, int fq) const {
        const int pn = u.pn; bf16_t* base; int ldc, colt;
        if (pn < 2) { base = (bf16_t*)(ws + WS_QG); ldc = 512; colt = pn * 256; }
        else if (pn < 4) { base = (bf16_t*)(ws + WS_KG); ldc = 512; colt = (pn - 2) * 256; }
        else if (pn < 12) { base = (bf16_t*)(ws + WS_VQ); ldc = 2048; colt = (pn - 4) * 256; }
        else if (pn < 16) { base = (bf16_t*)(ws + WS_KA); ldc = 1024; colt = (pn - 12) * 256; }
        else if (pn < 20) { base = (bf16_t*)(ws + WS_VA); ldc = 1024; colt = (pn - 16) * 256; }
        else if (pn < 24) { base = (bf16_t*)(ws + WS_GG); ldc = 1024; colt = (pn - 20) * 256; }
        else if (pn < 28) { base = (bf16_t*)(ws + WS_GA); ldc = 1024; colt = (pn - 24) * 256; }
        else { base = (bf16_t*)(ws + WS_CODE); ldc = 16; colt = 0; }
        const int row0 = u.pm * BM + wr * 64 + fr, col0 = colt + wc * 32 + 8 * fq;
        if (pn < 28) {
#pragma unroll
            for (int ai = 0; ai < 2; ++ai)
#pragma unroll
                for (int m = 0; m < 4; ++m) { bf16_t* rowp = base + (size_t)(row0 + ai * HALF + m * 16) * ldc + col0;
#pragma unroll
                    for (int bj = 0; bj < 2; ++bj) { const f32x4 v0 = acc[ai][bj][m][0], v1 = acc[ai][bj][m][1];
                        u32x4 w; w.x = cvt_pk_bf16(v0[0], v0[1]); w.y = cvt_pk_bf16(v0[2], v0[3]); w.z = cvt_pk_bf16(v1[0], v1[1]); w.w = cvt_pk_bf16(v1[2], v1[3]);
                        *(u32x4*)(rowp + bj * HALF) = w; } }
        } else if (wc == 0 && fq < 2) {
#pragma unroll
            for (int ai = 0; ai < 2; ++ai)
#pragma unroll
                for (int m = 0; m < 4; ++m) { bf16_t* rowp = base + (size_t)(row0 + ai * HALF + m * 16) * 16 + 8 * fq;
                    const f32x4 v0 = acc[ai][0][m][0], v1 = acc[ai][0][m][1];
                    u32x4 w; w.x = cvt_pk_bf16(v0[0], v0[1]); w.y = cvt_pk_bf16(v0[2], v0[3]); w.z = cvt_pk_bf16(v1[0], v1[1]); w.w = cvt_pk_bf16(v1[2], v1[3]);
                    *(u32x4*)rowp = w; }
        }
    }
};
struct EpiGates {
    static constexpr bool PERM = true, AFTER_DRAIN = false, HOOK = false;
    bf16_t* RATIO; bf16_t* SIGB; const float* mbias;
    __device__ __forceinline__ void operator()(const f32x4 (&acc)[2][2][4][2], const Unit& u, int wr, int wc, int fr, int fq) const {
        const int row0 = u.pm * BM + wr * 64 + fr, c0 = u.pn * 128 + wc * 32 + 8 * fq;
        f32x4 ba[2], bb[2];
#pragma unroll
        for (int n = 0; n < 2; ++n) { ba[n] = *(const f32x4*)(mbias + c0 + 4 * n); bb[n] = *(const f32x4*)(mbias + 1024 + c0 + 4 * n); }
#pragma unroll
        for (int ai = 0; ai < 2; ++ai)
#pragma unroll
            for (int m = 0; m < 4; ++m) { const size_t off = (size_t)(row0 + ai * HALF + m * 16) * 1024 + c0;
                float r[8], s[8];
#pragma unroll
                for (int n = 0; n < 2; ++n)
#pragma unroll
                    for (int e = 0; e < 4; ++e) { const float a = acc[ai][0][m][n][e] + ba[n][e], b = acc[ai][1][m][n][e] + bb[n][e];
                        const float ea = 1.0f + __expf(-a), eb = 1.0f + __expf(-b);
                        s[n * 4 + e] = 1.0f / eb; r[n * 4 + e] = eb / ea; }
                u32x4 wr_, ws_; wr_.x = cvt_pk_bf16(r[0], r[1]); wr_.y = cvt_pk_bf16(r[2], r[3]); wr_.z = cvt_pk_bf16(r[4], r[5]); wr_.w = cvt_pk_bf16(r[6], r[7]);
                ws_.x = cvt_pk_bf16(s[0], s[1]); ws_.y = cvt_pk_bf16(s[2], s[3]); ws_.z = cvt_pk_bf16(s[4], s[5]); ws_.w = cvt_pk_bf16(s[6], s[7]);
                *(u32x4*)(RATIO + off) = wr_; *(u32x4*)(SIGB + off) = ws_; }
    }
};
struct EpiT1 {
    static constexpr bool PERM = true, AFTER_DRAIN = false, HOOK = false;
    const bf16_t* RATIO; float* T1;
    __device__ __forceinline__ void mid(f32x4 (&acc)[2][2][4][2], const Unit& u, int wr, int wc, int fr, int fq) const {}
    __device__ __forceinline__ void operator()(const f32x4 (&acc)[2][2][4][2], const Unit& u, int wr, int wc, int fr, int fq) const {
        const int row0 = u.pm * BM + wr * 64 + fr, col0 = u.pn * BM + wc * 32 + 8 * fq;
#pragma unroll
        for (int ai = 0; ai < 2; ++ai)
#pragma unroll
            for (int m = 0; m < 4; ++m) { const size_t off = (size_t)(row0 + ai * HALF + m * 16) * 1024 + col0;
#pragma unroll
                for (int bj = 0; bj < 2; ++bj) { const u32x4 w = *(const u32x4*)(RATIO + off + bj * HALF);
                    *(f32x4*)(T1 + off + bj * HALF) = acc[ai][bj][m][0] * (f32x4){bflo(w.x), bfhi(w.x), bflo(w.y), bfhi(w.y)};
                    *(f32x4*)(T1 + off + bj * HALF + 4) = acc[ai][bj][m][1] * (f32x4){bflo(w.z), bfhi(w.z), bflo(w.w), bfhi(w.w)}; }
                if (m & 1) asm volatile("" ::: "memory"); }
    }
};
struct EpiMerge {
    static constexpr bool PERM = true, AFTER_DRAIN = false, HOOK = false;
    const float* T1; const bf16_t* SIGB; bf16_t* MERGED;
    __device__ __forceinline__ void mid(f32x4 (&acc)[2][2][4][2], const Unit& u, int wr, int wc, int fr, int fq) const {}
    __device__ __forceinline__ void operator()(const f32x4 (&acc)[2][2][4][2], const Unit& u, int wr, int wc, int fr, int fq) const {
        const int row0 = u.pm * BM + wr * 64 + fr, col0 = u.pn * BM + wc * 32 + 8 * fq;
#pragma unroll
        for (int ai = 0; ai < 2; ++ai)
#pragma unroll
            for (int m = 0; m < 4; ++m) { const size_t off = (size_t)(row0 + ai * HALF + m * 16) * 1024 + col0;
#pragma unroll
                for (int bj = 0; bj < 2; ++bj) { const u32x4 g = *(const u32x4*)(SIGB + off + bj * HALF);
                    const f32x4 t0 = *(const f32x4*)(T1 + off + bj * HALF), t1 = *(const f32x4*)(T1 + off + bj * HALF + 4);
                    const f32x4 v0 = (acc[ai][bj][m][0] + t0) * (f32x4){bflo(g.x), bfhi(g.x), bflo(g.y), bfhi(g.y)};
                    const f32x4 v1 = (acc[ai][bj][m][1] + t1) * (f32x4){bflo(g.z), bfhi(g.z), bflo(g.w), bfhi(g.w)};
                    u32x4 w; w.x = cvt_pk_bf16(v0[0], v0[1]); w.y = cvt_pk_bf16(v0[2], v0[3]); w.z = cvt_pk_bf16(v1[0], v1[1]); w.w = cvt_pk_bf16(v1[2], v1[3]);
                    *(u32x4*)(MERGED + off + bj * HALF) = w; }
                if (m & 1) asm volatile("" ::: "memory"); }
    }
};
struct EpiY {
    static constexpr bool PERM = false, AFTER_DRAIN = false, HOOK = false;
    float* Y; float* ssq;
    __device__ __forceinline__ void operator()(const f32x4 (&acc)[2][2][4][2], const Unit& u, int wr, int wc, int fr, int fq) const {
        const int row0 = u.pm * BM + wr * 64 + fr, col0 = u.pn * BM + wc * 32 + 4 * fq;
#pragma unroll
        for (int ai = 0; ai < 2; ++ai)
#pragma unroll
            for (int m = 0; m < 4; ++m) { const int row = row0 + ai * HALF + m * 16; float* rowp = Y + (size_t)row * 1024 + col0; float s = 0.f;
#pragma unroll
                for (int bj = 0; bj < 2; ++bj)
#pragma unroll
                    for (int n = 0; n < 2; ++n) { const f32x4 v = acc[ai][bj][m][n]; *(f32x4*)(rowp + bj * HALF + n * 16) = v; s += (v[0] * v[0] + v[1] * v[1]) + (v[2] * v[2] + v[3] * v[3]); }
                s += __shfl_xor(s, 16); s += __shfl_xor(s, 32);
                if (fq == 0) atomicAdd(ssq + row, s); }
    }
};
}

__device__ __forceinline__ int win_src_col(int n, float& sc) {
    sc = 1.0f;
    if (n < 512) { sc = 0.08838834764831845f; return n; }
    if (n < 1024) return n;
    if (n < 2048) return n;
    if (n < 3072) { sc = 0.125f; return 3088 + (n - 2048); }
    if (n < 4096) return 4112 + (n - 3072);
    if (n < 5120) return 5136 + (n - 4096);
    if (n < 6144) return 2048 + (n - 5120);
    if (n < 7168) return 6160 + (n - 6144);
    if (n < 7184) return 3072 + (n - 7168);
    return -1;
}
__device__ __forceinline__ void transpose_item(const float* W, int spitch, int k0, int scol, float sc, bf16_t* WT, int dpitch, int n0, int dk0, LAS float* scr, int lane) {
#pragma unroll 8
    for (int i = 0; i < 32; ++i) { const int kk = 2 * i + (lane >> 5); scr[kk * 33 + (lane & 31)] = scol >= 0 ? W[(size_t)(k0 + kk) * spitch + scol] * sc : 0.f; }
    LDS_WAIT();
    const int c = lane & 7;
#pragma unroll
    for (int j = 0; j < 4; ++j) { const int n = (lane >> 3) + 8 * j; const LAS float* s = scr + (8 * c) * 33 + n;
        u32x4 o; o.x = pk2(s[0 * 33], s[1 * 33]); o.y = pk2(s[2 * 33], s[3 * 33]); o.z = pk2(s[4 * 33], s[5 * 33]); o.w = pk2(s[6 * 33], s[7 * 33]);
        *(u32x4*)(WT + (size_t)(n0 + n) * dpitch + dk0 + 8 * c) = o; }
    LDS_WAIT();
}
__device__ __forceinline__ float wave_sum(float v) {
#pragma unroll
    for (int o = 1; o < 64; o <<= 1) v += __shfl_xor(v, o);
    return v;
}
struct Ptrs {
    const float *x, *g_pre, *w_in, *gk_up, *gk_bias, *gla_g, *rel_bias, *w_o_gla, *w_o_att, *mbias, *w_out, *g_post;
    float* out; unsigned char* ws;
};
__device__ __forceinline__ void p0_prologue(const Ptrs& P, LAS unsigned char* lds, int tid, int wave, int lane) {
    LAS float* scr = (LAS float*)(lds + wave * 16384);
    const int gw = blockIdx.x * 8 + wave, NGW = gridDim.x * 8;
    constexpr int I_IN = 16 * (N1 / 32), I_G = 16 * 64, I_O = 16 * 32, I_OUT = 16 * 32;
    constexpr int NITEMS = I_IN + I_G + 2 * I_O + I_OUT;
    bf16_t* WIN = (bf16_t*)(P.ws + WS_WIN); bf16_t* WG = (bf16_t*)(P.ws + WS_WG); bf16_t* WO = (bf16_t*)(P.ws + WS_WO); bf16_t* WOUT = (bf16_t*)(P.ws + WS_WOUT);
    for (int it = gw; it < NITEMS; it += NGW) {
        int r = it;
        if (r < I_IN) { const int kb = r / (N1 / 32), nb = r % (N1 / 32); float sc; const int scol = win_src_col(nb * 32 + (lane & 31), sc);
            transpose_item(P.w_in, IN_COLS, kb * 64, scol, sc, WIN, 1024, nb * 32, kb * 64, scr, lane); continue; }
        r -= I_IN;
        if (r < I_G) { const int kb = r / 64, nb = r % 64; const int n = nb * 32 + (lane & 31);
            const int j = n >> 8, bj = (n >> 7) & 1, i = n & 127;
            transpose_item(P.w_in, IN_COLS, kb * 64, 7184 + bj * 1024 + 128 * j + i, 1.0f, WG, 1024, nb * 32, kb * 64, scr, lane); continue; }
        r -= I_G;
        if (r < I_O) { const int kb = r / 32, nb = r % 32; transpose_item(P.w_o_gla, 1024, kb * 64, nb * 32 + (lane & 31), 1.0f, WO, 2048, nb * 32, kb * 64, scr, lane); continue; }
        r -= I_O;
        if (r < I_O) { const int kb = r / 32, nb = r % 32; transpose_item(P.w_o_att, 1024, kb * 64, nb * 32 + (lane & 31), 1.0f, WO, 2048, nb * 32, 1024 + kb * 64, scr, lane); continue; }
        r -= I_O;
        { const int kb = r / 32, nb = r % 32; transpose_item(P.w_out, 1024, kb * 64, nb * 32 + (lane & 31), 1.0f, WOUT, 1024, nb * 32, kb * 64, scr, lane); }
    }
    bf16_t* XN = (bf16_t*)P.out;
    f32x4 g[4];
#pragma unroll
    for (int j = 0; j < 4; ++j) g[j] = ((const f32x4*)P.g_pre)[lane + 64 * j];
    for (int m = gw; m < M; m += NGW) {
        const f32x4* xr = (const f32x4*)(P.x + (size_t)m * D) + lane;
        f32x4 v[4]; float s = 0.f;
#pragma unroll
        for (int j = 0; j < 4; ++j) { v[j] = xr[64 * j]; s += (v[j].x * v[j].x + v[j].y * v[j].y) + (v[j].z * v[j].z + v[j].w * v[j].w); }
        const float rs = 1.0f / sqrtf(wave_sum(s) * (1.f / D) + EPS);
        unsigned long long* o8 = (unsigned long long*)(XN + (size_t)m * D) + lane;
#pragma unroll
        for (int j = 0; j < 4; ++j) { const f32x4 t = v[j] * rs * g[j]; o8[64 * j] = (unsigned long long)pk2(t.x, t.y) | ((unsigned long long)pk2(t.z, t.w) << 32); }
    }
    unsigned* ctl = (unsigned*)(P.ws + WS_CTL);
    for (int i = blockIdx.x * NTHREADS + tid; i < CTL_SSQ + M; i += gridDim.x * NTHREADS) ctl[i] = 0u;
}

constexpr int VPB = 144;
__device__ __forceinline__ s16x4 tr_read(const LAS unsigned char* p) { return __builtin_bit_cast(s16x4, __builtin_amdgcn_ds_read_tr16_b64_v4i16((LAS s16x4*)p)); }
__device__ __forceinline__ void attn_wave_unit(int b, int h, int c, int half, const bf16_t* __restrict__ KA, const bf16_t* __restrict__ VA, bf16_t* VQ, const bf16_t* __restrict__ GA,
                                               const LAS float* biasT, LAS unsigned char* vlds, int lane) {
    const int r = lane & 31, hh = lane >> 5;
    const size_t tok0 = (size_t)b * T;
    const int qpos = 64 * c + 32 * half + r;
    bf16_t* qrow = VQ + (tok0 + qpos) * 2048 + 1024 + h * 64;
    bf16x8 qf[4];
#pragma unroll
    for (int s = 0; s < 4; ++s) qf[s] = *(const bf16x8*)(qrow + 16 * s + 8 * hh);
    f32x16 o0, o1;
#pragma unroll
    for (int i = 0; i < 16; ++i) { o0[i] = 0.f; o1[i] = 0.f; }
    float mrun = -1e30f, lrun = 0.f;
    const int j0 = c > 8 ? c - 8 : 0;
    const LAS unsigned char* vrd = vlds + (4 * hh + ((lane & 15) >> 2)) * VPB + (16 * ((lane >> 4) & 1) + 4 * (lane & 3)) * 2;
    for (int j = j0; j <= c; ++j) {
        const bf16_t* vsrc = VA + (tok0 + 64 * j) * 1024 + h * 64;
        u32x4 vv[8];
#pragma unroll
        for (int i = 0; i < 8; ++i) vv[i] = *(const u32x4*)(vsrc + (size_t)((lane >> 3) + 8 * i) * 1024 + (lane & 7) * 8);
        const bf16_t* kp = KA + (tok0 + 64 * j + r) * 1024 + h * 64 + 8 * hh;
        bf16x8 kf[2][4];
#pragma unroll
        for (int kt = 0; kt < 2; ++kt)
#pragma unroll
            for (int s = 0; s < 4; ++s) kf[kt][s] = *(const bf16x8*)(kp + (size_t)kt * 32 * 1024 + 16 * s);
        asm volatile("" ::: "memory");
#pragma unroll
        for (int i = 0; i < 8; ++i) *(LAS u32x4*)(vlds + ((lane >> 3) + 8 * i) * VPB + (lane & 7) * 16) = vv[i];
        f32x16 p0, p1;
#pragma unroll
        for (int i = 0; i < 16; ++i) { p0[i] = 0.f; p1[i] = 0.f; }
#pragma unroll
        for (int s = 0; s < 4; ++s) { p0 = __builtin_amdgcn_mfma_f32_32x32x16_bf16(kf[0][s], qf[s], p0, 0, 0, 0); p1 = __builtin_amdgcn_mfma_f32_32x32x16_bf16(kf[1][s], qf[s], p1, 0, 0, 0); }
        if (c - j >= 5) { const float bb = biasT[512];
#pragma unroll
            for (int i = 0; i < 16; ++i) { p0[i] += bb; p1[i] += bb; }
        } else { const int d0 = qpos - 64 * j - 4 * hh + 256;
#pragma unroll
            for (int i = 0; i < 16; ++i) { const int x0 = d0 - ((i & 3) + 8 * (i >> 2)); const int x1 = x0 - 32;
                p0[i] += biasT[x0 > 512 ? 512 : x0]; p1[i] += biasT[x1 > 512 ? 512 : x1]; }
        }
        float mx = p0[0];
#pragma unroll
        for (int i = 1; i < 16; ++i) mx = fmaxf(mx, p0[i]);
#pragma unroll
        for (int i = 0; i < 16; ++i) mx = fmaxf(mx, p1[i]);
        mx = fmaxf(mx, __shfl_xor(mx, 32));
        const float mnew = fmaxf(mrun, mx), alpha = __expf(mrun - mnew);
        float rs = 0.f;
#pragma unroll
        for (int i = 0; i < 16; ++i) { p0[i] = __expf(p0[i] - mnew); p1[i] = __expf(p1[i] - mnew); rs += p0[i] + p1[i]; }
        lrun = lrun * alpha + rs; mrun = mnew;
#pragma unroll
        for (int i = 0; i < 16; ++i) { o0[i] *= alpha; o1[i] *= alpha; }
        u32x4 pb[2][2];
#pragma unroll
        for (int s = 0; s < 2; ++s) {
            pb[0][s].x = pk2(p0[8 * s + 0], p0[8 * s + 1]); pb[0][s].y = pk2(p0[8 * s + 2], p0[8 * s + 3]); pb[0][s].z = pk2(p0[8 * s + 4], p0[8 * s + 5]); pb[0][s].w = pk2(p0[8 * s + 6], p0[8 * s + 7]);
            pb[1][s].x = pk2(p1[8 * s + 0], p1[8 * s + 1]); pb[1][s].y = pk2(p1[8 * s + 2], p1[8 * s + 3]); pb[1][s].z = pk2(p1[8 * s + 4], p1[8 * s + 5]); pb[1][s].w = pk2(p1[8 * s + 6], p1[8 * s + 7]);
        }
        LDS_WAIT();
#pragma unroll
        for (int kt = 0; kt < 2; ++kt)
#pragma unroll
            for (int s = 0; s < 2; ++s) {
                const LAS unsigned char* vb = vrd + (32 * kt + 16 * s) * VPB;
                const s16x4 a0l = tr_read(vb), a0h = tr_read(vb + 8 * VPB), a1l = tr_read(vb + 64), a1h = tr_read(vb + 8 * VPB + 64);
                const bf16x8 A0 = (bf16x8){a0l[0], a0l[1], a0l[2], a0l[3], a0h[0], a0h[1], a0h[2], a0h[3]};
                const bf16x8 A1 = (bf16x8){a1l[0], a1l[1], a1l[2], a1l[3], a1h[0], a1h[1], a1h[2], a1h[3]};
                const bf16x8 Bp = __builtin_bit_cast(bf16x8, pb[kt][s]);
                o0 = __builtin_amdgcn_mfma_f32_32x32x16_bf16(A0, Bp, o0, 0, 0, 0);
                o1 = __builtin_amdgcn_mfma_f32_32x32x16_bf16(A1, Bp, o1, 0, 0, 0);
            }
        LDS_WAIT();
    }
    const float ltot = lrun + __shfl_xor(lrun, 32), inv = 1.0f / ltot;
    const bf16_t* grow = GA + (tok0 + qpos) * 1024 + h * 64;
#pragma unroll
    for (int dt = 0; dt < 2; ++dt)
#pragma unroll
        for (int g = 0; g < 4; ++g) { const int d = 32 * dt + 8 * g + 4 * hh;
            const u32x2 gw = *(const u32x2*)(grow + d);
            const float v0 = (dt ? o1[4 * g + 0] : o0[4 * g + 0]) * inv * siluf_(bflo(gw.x)), v1 = (dt ? o1[4 * g + 1] : o0[4 * g + 1]) * inv * siluf_(bfhi(gw.x));
            const float v2 = (dt ? o1[4 * g + 2] : o0[4 * g + 2]) * inv * siluf_(bflo(gw.y)), v3 = (dt ? o1[4 * g + 3] : o0[4 * g + 3]) * inv * siluf_(bfhi(gw.y));
            u32x2 w; w.x = pk2(v0, v1); w.y = pk2(v2, v3);
            *(u32x2*)(qrow + d) = w; }
}

constexpr int G_KD = 0, G_KDP = 144;
constexpr int G_VL = 18432, G_VLP = 528;
constexpr int G_QL = G_VL + 64 * 528, G_QLP = 272;
constexpr int G_DEC = G_QL + 64 * 272;
constexpr int G_CS = G_DEC + 512;
constexpr int G_SSQ = G_CS + 2048;
constexpr int G_END = G_SSQ + 2048;
__device__ __forceinline__ void gla_unit(int b, int hd, const Ptrs& P, LAS unsigned char* lds, int tid, int wave, int lane) {
    const bf16_t* QG = (const bf16_t*)(P.ws + WS_QG); const bf16_t* KG = (const bf16_t*)(P.ws + WS_KG); bf16_t* VQ = (bf16_t*)(P.ws + WS_VQ);
    const bf16_t* GG = (const bf16_t*)(P.ws + WS_GG); const bf16_t* CODE = (const bf16_t*)(P.ws + WS_CODE);
    const int dk = tid & 127, tq = tid >> 7, r = lane & 31, h2 = lane >> 5;
    float up[16];
#pragma unroll
    for (int i = 0; i < 16; ++i) up[i] = P.gk_up[i * 512 + hd * 128 + dk];
    const float ubias = P.gk_bias[hd * 128 + dk];
    f32x16 S[4];
#pragma unroll
    for (int i = 0; i < 4; ++i)
#pragma unroll
        for (int e = 0; e < 16; ++e) S[i][e] = 0.f;
    LAS float* DEC = (LAS float*)(lds + G_DEC); LAS float* CS = (LAS float*)(lds + G_CS); LAS float* SSQ = (LAS float*)(lds + G_SSQ);
    for (int n = 0; n < NCH; ++n) {
        const size_t tokbase = (size_t)b * T + 64 * n;
        float acum[16]; float run = 0.f;
#pragma unroll
        for (int tt = 0; tt < 16; ++tt) { const size_t tok = tokbase + 16 * tq + tt;
            const u32x4 c0 = *(const u32x4*)(CODE + tok * 16), c1 = *(const u32x4*)(CODE + tok * 16 + 8);
            float z = ubias;
            z += bflo(c0.x) * up[0] + bfhi(c0.x) * up[1] + bflo(c0.y) * up[2] + bfhi(c0.y) * up[3] + bflo(c0.z) * up[4] + bfhi(c0.z) * up[5] + bflo(c0.w) * up[6] + bfhi(c0.w) * up[7];
            z += bflo(c1.x) * up[8] + bfhi(c1.x) * up[9] + bflo(c1.y) * up[10] + bfhi(c1.y) * up[11] + bflo(c1.z) * up[12] + bfhi(c1.z) * up[13] + bflo(c1.w) * up[14] + bfhi(c1.w) * up[15];
            const float ls = fminf(z, 0.f) - log1pf(__expf(-fabsf(z)));
            run += ls * (1.0f / 16.0f); acum[tt] = run; }
        CS[tq * 128 + dk] = run;
        float kv[16];
#pragma unroll
        for (int tt = 0; tt < 16; ++tt) kv[tt] = bf2f(KG[(tokbase + 16 * tq + tt) * 512 + hd * 128 + dk]);
        u32x4 vst[4], qst[2];
#pragma unroll
        for (int i = 0; i < 4; ++i) { const int id = tid + 512 * i, row = id >> 5, ch = id & 31; vst[i] = *(const u32x4*)(VQ + (tokbase + row) * 2048 + hd * 256 + ch * 8); }
#pragma unroll
        for (int i = 0; i < 2; ++i) { const int id = tid + 512 * i, row = id >> 4, ch = id & 15; qst[i] = *(const u32x4*)(QG + (tokbase + row) * 512 + hd * 128 + ch * 8); }
        __syncthreads();
        float pre = 0.f, aend = 0.f;
#pragma unroll
        for (int q = 0; q < 4; ++q) { const float cs = CS[q * 128 + dk]; aend += cs; if (q < tq) pre += cs; }
        unsigned kw[8];
#pragma unroll
        for (int tt = 0; tt < 16; tt += 2) kw[tt >> 1] = pk2(kv[tt] * __expf(aend - (pre + acum[tt])), kv[tt + 1] * __expf(aend - (pre + acum[tt + 1])));
        *(LAS u32x4*)(lds + G_KD + dk * G_KDP + tq * 32) = (u32x4){kw[0], kw[1], kw[2], kw[3]};
        *(LAS u32x4*)(lds + G_KD + dk * G_KDP + tq * 32 + 16) = (u32x4){kw[4], kw[5], kw[6], kw[7]};
        if (tq == 0) DEC[dk] = __expf(aend);
#pragma unroll
        for (int i = 0; i < 4; ++i) { const int id = tid + 512 * i, row = id >> 5, ch = id & 31; *(LAS u32x4*)(lds + G_VL + row * G_VLP + ch * 16) = vst[i]; }
#pragma unroll
        for (int i = 0; i < 2; ++i) { const int id = tid + 512 * i, row = id >> 4, ch = id & 15; *(LAS u32x4*)(lds + G_QL + row * G_QLP + ch * 16) = qst[i]; }
        __syncthreads();
#pragma unroll
        for (int i = 0; i < 4; ++i)
#pragma unroll
            for (int e = 0; e < 16; ++e) S[i][e] *= DEC[32 * i + (e & 3) + 8 * (e >> 2) + 4 * h2];
        const LAS unsigned char* vb = lds + G_VL + (8 * h2 + ((lane & 15) >> 2)) * G_VLP + (32 * wave + 16 * ((lane >> 4) & 1) + 4 * (lane & 3)) * 2;
#pragma unroll
        for (int s = 0; s < 4; ++s) {
            const s16x4 bl = tr_read(vb + (16 * s) * G_VLP), bh = tr_read(vb + (16 * s + 4) * G_VLP);
            const bf16x8 Bv = (bf16x8){bl[0], bl[1], bl[2], bl[3], bh[0], bh[1], bh[2], bh[3]};
#pragma unroll
            for (int i = 0; i < 4; ++i) { const bf16x8 Ak = *(const LAS bf16x8*)(lds + G_KD + (32 * i + r) * G_KDP + (16 * s + 8 * h2) * 2);
                S[i] = __builtin_amdgcn_mfma_f32_32x32x16_bf16(Ak, Bv, S[i], 0, 0, 0); }
        }
        f32x16 O[2];
#pragma unroll
        for (int e = 0; e < 16; ++e) { O[0][e] = 0.f; O[1][e] = 0.f; }
#pragma unroll
        for (int i = 0; i < 4; ++i)
#pragma unroll
            for (int s2 = 0; s2 < 2; ++s2) {
                u32x4 aw; aw.x = pk2(S[i][8 * s2 + 0], S[i][8 * s2 + 1]); aw.y = pk2(S[i][8 * s2 + 2], S[i][8 * s2 + 3]); aw.z = pk2(S[i][8 * s2 + 4], S[i][8 * s2 + 5]); aw.w = pk2(S[i][8 * s2 + 6], S[i][8 * s2 + 7]);
                const bf16x8 As = __builtin_bit_cast(bf16x8, aw);
#pragma unroll
                for (int tt = 0; tt < 2; ++tt) { const LAS unsigned char* qp = lds + G_QL + (32 * tt + r) * G_QLP + (32 * i + 16 * s2 + 4 * h2) * 2;
                    const u32x2 lo = *(const LAS u32x2*)qp, hi = *(const LAS u32x2*)(qp + 16);
                    const bf16x8 Bq = __builtin_bit_cast(bf16x8, (u32x4){lo.x, lo.y, hi.x, hi.y});
                    O[tt] = __builtin_amdgcn_mfma_f32_32x32x16_bf16(As, Bq, O[tt], 0, 0, 0); }
            }
#pragma unroll
        for (int tt = 0; tt < 2; ++tt) { float ss = 0.f;
#pragma unroll
            for (int e = 0; e < 16; ++e) ss += O[tt][e] * O[tt][e];
            ss += __shfl_xor(ss, 32);
            if (h2 == 0) SSQ[wave * 64 + 32 * tt + r] = ss; }
        __syncthreads();
#pragma unroll
        for (int tt = 0; tt < 2; ++tt) { float tot = 0.f;
#pragma unroll
            for (int w = 0; w < 8; ++w) tot += SSQ[w * 64 + 32 * tt + r];
            const float rs = 1.0f / sqrtf(tot * (1.0f / 256.0f) + EPS);
            const size_t tok = tokbase + 32 * tt + r;
#pragma unroll
            for (int g = 0; g < 4; ++g) { const int dv = 32 * wave + 8 * g + 4 * h2; const int col = hd * 256 + dv;
                const u32x2 gw = *(const u32x2*)(GG + tok * 1024 + col); const f32x4 gn = *(const f32x4*)(P.gla_g + dv);
                const float v0 = O[tt][4 * g + 0] * rs * gn.x * siluf_(bflo(gw.x)), v1 = O[tt][4 * g + 1] * rs * gn.y * siluf_(bfhi(gw.x));
                const float v2 = O[tt][4 * g + 2] * rs * gn.z * siluf_(bflo(gw.y)), v3 = O[tt][4 * g + 3] * rs * gn.w * siluf_(bfhi(gw.y));
                u32x2 w; w.x = pk2(v0, v1); w.y = pk2(v2, v3);
                *(u32x2*)(VQ + tok * 2048 + col) = w; }
        }
        __syncthreads();
    }
}

__global__ void __launch_bounds__(NTHREADS, 2) fwd_mega(Ptrs P) {
    extern __shared__ __attribute__((aligned(16))) unsigned char lds_raw[];
    cg::grid_group grid = cg::this_grid();
    LAS unsigned char* lds = (LAS unsigned char*)lds_raw;
    const int tid = threadIdx.x, lane = tid & 63, wave = __builtin_amdgcn_readfirstlane(tid >> 6);
    const int G = gridDim.x;
    unsigned char* ws = P.ws;
    bf16_t* XN = (bf16_t*)P.out;
    unsigned* ctl = (unsigned*)(ws + WS_CTL);

    p0_prologue(P, lds, tid, wave, lane);
    grid.sync();
    {
        pg8::Gemm g{XN, (const bf16_t*)(ws + WS_WIN), M, N1, D, D, D}; pg8::StaticOrder S; S.init(M, N1, G, (int)blockIdx.x);
        pg8::EpiProj E{ws};
        pg8::gemm_phase<pg8::EpiProj, pg8::StaticOrder, true, true>(lds, g, S, E);
    }
    grid.sync();
    {
        const bf16_t* KA = (const bf16_t*)(ws + WS_KA); const bf16_t* VA = (const bf16_t*)(ws + WS_VA); bf16_t* VQ = (bf16_t*)(ws + WS_VQ); const bf16_t* GA = (const bf16_t*)(ws + WS_GA);
        if (blockIdx.x < 64) gla_unit(blockIdx.x >> 2, blockIdx.x & 3, P, lds, tid, wave, lane);
        __syncthreads();
        LAS float* biasT = (LAS float*)lds; LAS unsigned* slot = (LAS unsigned*)(lds + 2560);
        int cur_h = -1;
        for (;;) {
            __syncthreads();
            if (tid == 0) slot[0] = atomicAdd(ctl + CTL_CNT, 1u);
            __syncthreads();
            const unsigned u = slot[0];
            if (u >= (unsigned)(NB * 16 * 8)) break;
            const int cg4 = u & 7, h = (u >> 3) & 15, b = u >> 7;
            if (h != cur_h) { __syncthreads(); for (int i = tid; i < 513; i += NTHREADS) biasT[i] = P.rel_bias[h * 513 + i]; cur_h = h; __syncthreads(); }
            attn_wave_unit(b, h, cg4 * 4 + (wave >> 1), wave & 1, KA, VA, VQ, GA, biasT, lds + 4096 + wave * (64 * VPB), lane);
        }
    }
    grid.sync();
    {
        pg8::Gemm g{XN, (const bf16_t*)(ws + WS_WG), M, 2048, D, D, D}; pg8::StaticOrder S; S.init(M, 2048, G, (int)blockIdx.x);
        pg8::EpiGates E{(bf16_t*)(ws + WS_KA), (bf16_t*)(ws + WS_VA), P.mbias};
        pg8::gemm_phase<pg8::EpiGates, pg8::StaticOrder, true, true>(lds, g, S, E);
    }
    grid.sync();
    {
        pg8::StaticOrder S; S.init(M, D, G, (int)blockIdx.x);
        { pg8::Gemm g{(const bf16_t*)(ws + WS_VQ), (const bf16_t*)(ws + WS_WO), M, D, D, 2048, 2048};
          pg8::EpiT1 E{(const bf16_t*)(ws + WS_KA), (float*)(ws + WS_GG)};
          pg8::gemm_phase<pg8::EpiT1, pg8::StaticOrder, true, true>(lds, g, S, E); }
        __syncthreads();
        { pg8::Gemm g{(const bf16_t*)(ws + WS_VQ) + 1024, (const bf16_t*)(ws + WS_WO) + 1024, M, D, D, 2048, 2048};
          pg8::EpiMerge E{(const float*)(ws + WS_GG), (const bf16_t*)(ws + WS_VA), (bf16_t*)(ws + WS_QG)};
          pg8::gemm_phase<pg8::EpiMerge, pg8::StaticOrder, true, true>(lds, g, S, E); }
    }
    grid.sync();
    {
        pg8::Gemm g{(const bf16_t*)(ws + WS_QG), (const bf16_t*)(ws + WS_WOUT), M, D, D, D, D}; pg8::StaticOrder S; S.init(M, D, G, (int)blockIdx.x);
        pg8::EpiY E{(float*)(ws + WS_GG), (float*)(ctl + CTL_SSQ)};
        pg8::gemm_phase<pg8::EpiY, pg8::StaticOrder, true, true>(lds, g, S, E);
    }
    grid.sync();
    {
        const float* Y = (const float*)(ws + WS_GG); const float* ssq = (const float*)(ctl + CTL_SSQ);
        const int gw = blockIdx.x * 8 + wave, NGW = G * 8;
        f32x4 g[4];
#pragma unroll
        for (int j = 0; j < 4; ++j) g[j] = ((const f32x4*)P.g_post)[lane + 64 * j];
        for (int m = gw; m < M; m += NGW) {
            const float rs = 1.0f / sqrtf(ssq[m] * (1.f / D) + EPS);
            const f32x4* yr = (const f32x4*)(Y + (size_t)m * D) + lane; const f32x4* xr = (const f32x4*)(P.x + (size_t)m * D) + lane; f32x4* orow = (f32x4*)(P.out + (size_t)m * D) + lane;
#pragma unroll
            for (int j = 0; j < 4; ++j) orow[64 * j] = xr[64 * j] + yr[64 * j] * rs * g[j];
        }
    }
}

extern "C" void kernel_launch(void* const* d_in, const int* in_sizes, int n_in, void* d_out, int out_size, void* d_ws, size_t ws_size, hipStream_t stream) {
    static int grid_blocks = 0;
    if (!grid_blocks) {
        int dev = 0, cus = 0, per_cu = 0;
        hipGetDevice(&dev);
        hipDeviceGetAttribute(&cus, hipDeviceAttributeMultiprocessorCount, dev);
        hipFuncSetAttribute((const void*)fwd_mega, hipFuncAttributeMaxDynamicSharedMemorySize, LDS_BYTES);
        hipOccupancyMaxActiveBlocksPerMultiprocessor(&per_cu, (const void*)fwd_mega, NTHREADS, LDS_BYTES);
        if (per_cu < 1) per_cu = 1;
        if (per_cu > 1) per_cu = 1;
        grid_blocks = cus * per_cu;
        if (ws_size < WS_END) fprintf(stderr, "kernel_launch: workspace too small: %zu < %zu\n", ws_size, (size_t)WS_END);
    }
    Ptrs p{};
    p.x = (const float*)d_in[0]; p.g_pre = (const float*)d_in[1]; p.w_in = (const float*)d_in[2]; p.gk_up = (const float*)d_in[3]; p.gk_bias = (const float*)d_in[4];
    p.gla_g = (const float*)d_in[5]; p.rel_bias = (const float*)d_in[6]; p.w_o_gla = (const float*)d_in[7]; p.w_o_att = (const float*)d_in[8]; p.mbias = (const float*)d_in[9];
    p.w_out = (const float*)d_in[10]; p.g_post = (const float*)d_in[11]; p.out = (float*)d_out; p.ws = (unsigned char*)d_ws;
    void* args[] = {&p};
    hipError_t e = hipLaunchCooperativeKernel((const void*)fwd_mega, dim3(grid_blocks), dim3(NTHREADS), args, LDS_BYTES, stream);
    if (e != hipSuccess) fprintf(stderr, "cooperative launch failed: %s (grid %d)\n", hipGetErrorString(e), grid_blocks);
}
```
